# Optimizing an MI355X kernel written in HIP

```python
import jax, jax.numpy as jnp
from jax import lax
import numpy as np

D_MODEL = 1024
BATCH = 4
SEQ = 4096
DEPTH = 1

ATTN_HEADS = 8
ATTN_KV_HEADS = 2
ATTN_HEAD_DIM = 64
WINDOW = 128
DN_HEADS = 4
DN_KEY_DIM = 128
DN_VALUE_DIM = 128
CONV_WIDTH = 4
CHUNK = 64
D_FF = 4 * D_MODEL
LN_EPS = 1e-5
RMS_EPS = 1e-6
DEEPNORM_ALPHA = (2 * DEPTH) ** 0.25
DEEPNORM_BETA = (8 * DEPTH) ** -0.25

ATTN_Q_W = ATTN_HEADS * ATTN_HEAD_DIM
ATTN_KV_W = ATTN_KV_HEADS * ATTN_HEAD_DIM
DN_QK_W = DN_HEADS * DN_KEY_DIM
DN_V_W = DN_HEADS * DN_VALUE_DIM
DN_CONV_W = 2 * DN_QK_W + DN_V_W
GATE_W = 2 * D_MODEL
SPLIT_POINTS = (
    ATTN_Q_W,
    ATTN_Q_W + ATTN_KV_W,
    ATTN_Q_W + 2 * ATTN_KV_W,
    ATTN_Q_W + 2 * ATTN_KV_W + DN_CONV_W,
    ATTN_Q_W + 2 * ATTN_KV_W + DN_CONV_W + DN_V_W,
    ATTN_Q_W + 2 * ATTN_KV_W + DN_CONV_W + DN_V_W + DN_HEADS,
    ATTN_Q_W + 2 * ATTN_KV_W + DN_CONV_W + DN_V_W + 2 * DN_HEADS,
)
IN_WIDTH = ATTN_Q_W + 2 * ATTN_KV_W + DN_CONV_W + DN_V_W + 2 * DN_HEADS + GATE_W

kernel_name = "hybrid_swa_sink_gated_deltanet_deepnorm"


def layer_norm(x, g, b):
    xf = x.astype(jnp.float32)
    mu = jnp.mean(xf, axis=-1, keepdims=True)
    var = jnp.mean(jnp.square(xf - mu), axis=-1, keepdims=True)
    return ((xf - mu) * lax.rsqrt(var + LN_EPS) * g + b).astype(x.dtype)


def l2_normalize(x):
    xf = x.astype(jnp.float32)
    return xf * lax.rsqrt(jnp.sum(xf * xf, axis=-1, keepdims=True) + RMS_EPS)


def sliding_window_attention_with_sinks(q, k, v, sinks):
    B, T, Hq, hd = q.shape
    Hkv = k.shape[2]
    G = Hq // Hkv
    n = T // WINDOW
    qb = q.reshape(B, n, WINDOW, Hkv, G, hd)
    kb = k.reshape(B, n, WINDOW, Hkv, hd)
    vb = v.reshape(B, n, WINDOW, Hkv, hd)
    pad = ((0, 0), (1, 0), (0, 0), (0, 0), (0, 0))
    kk = jnp.concatenate([jnp.pad(kb, pad)[:, :-1], kb], axis=2)
    vv = jnp.concatenate([jnp.pad(vb, pad)[:, :-1], vb], axis=2)
    s = jnp.einsum('bnqhgd,bnkhd->bnhgqk', qb, kk).astype(jnp.float32) * (hd ** -0.5)
    qi = jnp.arange(WINDOW)[:, None] + WINDOW
    kj = jnp.arange(2 * WINDOW)[None, :]
    band = (kj <= qi) & (qi - kj < WINDOW)
    has_prev = (jnp.arange(n)[:, None, None] > 0) | (kj[None] >= WINDOW)
    mask = band[None] & has_prev
    s = jnp.where(mask[None, :, None, None], s, -1e30)
    sink = jnp.broadcast_to(sinks.astype(jnp.float32).reshape(1, 1, Hkv, G, 1, 1), s.shape[:-1] + (1,))
    p = jax.nn.softmax(jnp.concatenate([s, sink], axis=-1), axis=-1)[..., :-1]
    o = jnp.einsum('bnhgqk,bnkhd->bnqhgd', p.astype(v.dtype), vv)
    return o.reshape(B, T, Hq * hd)


def causal_depthwise_conv(x, w):
    K, C = w.shape
    return lax.conv_general_dilated(
        x, w[:, None, :].astype(x.dtype), window_strides=(1,), padding=[(K - 1, 0)],
        dimension_numbers=('NWC', 'WIO', 'NWC'), feature_group_count=C)


def gated_delta_rule_chunked(q, k, v, g, beta):
    B, T, H, dk = q.shape
    dv = v.shape[-1]
    n = T // CHUNK

    def chunks(t):
        return t.astype(jnp.float32).reshape(B, n, CHUNK, H, -1).transpose(1, 0, 3, 2, 4)

    q = chunks(q) * (dk ** -0.5)
    k = chunks(k)
    v = chunks(v)
    g = g.astype(jnp.float32).reshape(B, n, CHUNK, H).transpose(1, 0, 3, 2)
    beta = beta.astype(jnp.float32).reshape(B, n, CHUNK, H).transpose(1, 0, 3, 2)
    g = jnp.cumsum(g, axis=-1)
    causal = jnp.tril(jnp.ones((CHUNK, CHUNK), dtype=bool))
    strict = jnp.tril(jnp.ones((CHUNK, CHUNK), dtype=bool), -1)
    decay = jnp.exp(jnp.where(causal, g[..., :, None] - g[..., None, :], -jnp.inf))
    k_beta = k * beta[..., None]
    v_beta = v * beta[..., None]
    a = jnp.where(strict, jnp.einsum('nbhcd,nbhsd->nbhcs', k_beta, k) * decay, 0.0)
    eye = jnp.eye(CHUNK, dtype=jnp.float32)
    t_inv = lax.linalg.triangular_solve(eye + a, jnp.broadcast_to(eye, a.shape),
                                        left_side=True, lower=True, unit_diagonal=True)
    u = jnp.einsum('nbhcs,nbhse->nbhce', t_inv, v_beta)
    w = jnp.einsum('nbhcs,nbhsd->nbhcd', t_inv, k_beta * jnp.exp(g)[..., None])
    attn_intra = jnp.where(causal, jnp.einsum('nbhcd,nbhsd->nbhcs', q, k) * decay, 0.0)

    def step(state, inp):
        q_c, k_c, u_c, w_c, g_c, a_c = inp
        v_new = u_c - jnp.einsum('bhcd,bhde->bhce', w_c, state)
        o_c = (jnp.einsum('bhcd,bhde->bhce', q_c * jnp.exp(g_c)[..., None], state)
               + jnp.einsum('bhcs,bhse->bhce', a_c, v_new))
        g_last = g_c[..., -1]
        k_dec = k_c * jnp.exp(g_last[..., None] - g_c)[..., None]
        state = state * jnp.exp(g_last)[..., None, None] + jnp.einsum('bhcd,bhce->bhde', k_dec, v_new)
        return state, o_c

    state0 = jnp.zeros((B, H, dk, dv), dtype=jnp.float32)
    _, o = lax.scan(step, state0, (q, k, u, w, g, attn_intra))
    return o.transpose(1, 0, 3, 2, 4).reshape(B, T, H, dv)


def hybrid_mixer(x, w_in, conv_w, attn_sinks, dn_a_log, dn_dt_bias, dn_norm_w, w_attn_out, w_dn_out, w_out):
    B, T, _ = x.shape
    proj = x @ w_in
    aq, ak, av, dqkv, dz, db, da, gates = jnp.split(proj, SPLIT_POINTS, axis=-1)
    y_a = sliding_window_attention_with_sinks(
        aq.reshape(B, T, ATTN_HEADS, ATTN_HEAD_DIM),
        ak.reshape(B, T, ATTN_KV_HEADS, ATTN_HEAD_DIM),
        av.reshape(B, T, ATTN_KV_HEADS, ATTN_HEAD_DIM), attn_sinks) @ w_attn_out
    qkv = jax.nn.silu(causal_depthwise_conv(dqkv, conv_w))
    dq, dk_, dv_ = jnp.split(qkv, (DN_QK_W, 2 * DN_QK_W), axis=-1)
    dq = l2_normalize(dq.reshape(B, T, DN_HEADS, DN_KEY_DIM))
    dk_ = l2_normalize(dk_.reshape(B, T, DN_HEADS, DN_KEY_DIM))
    dv_ = dv_.reshape(B, T, DN_HEADS, DN_VALUE_DIM)
    g = -jnp.exp(dn_a_log.astype(jnp.float32)) * jax.nn.softplus(da.astype(jnp.float32) + dn_dt_bias.astype(jnp.float32))
    beta = jax.nn.sigmoid(db.astype(jnp.float32))
    o = gated_delta_rule_chunked(dq, dk_, dv_, g, beta)
    o = o * lax.rsqrt(jnp.mean(o * o, axis=-1, keepdims=True) + RMS_EPS) * dn_norm_w
    o = o * jax.nn.silu(dz.astype(jnp.float32).reshape(B, T, DN_HEADS, DN_VALUE_DIM))
    y_b = o.reshape(B, T, DN_V_W).astype(x.dtype) @ w_dn_out
    g_a, g_b = jnp.split(gates, 2, axis=-1)
    merged = jax.nn.sigmoid(g_a) * y_a + jax.nn.sigmoid(g_b) * y_b
    return merged @ w_out


def setup_inputs(seed: int = 0) -> dict:
    key = jax.random.key(seed)
    ks = jax.random.split(key, 16)
    f32 = jnp.float32
    x = jax.random.normal(ks[0], (BATCH, SEQ, D_MODEL), f32)
    w_in = jax.random.normal(ks[1], (DEPTH, D_MODEL, IN_WIDTH), f32) * D_MODEL ** -0.5
    conv_w = jax.random.normal(ks[2], (DEPTH, CONV_WIDTH, DN_CONV_W), f32) * CONV_WIDTH ** -0.5
    attn_sinks = jax.random.normal(ks[3], (DEPTH, ATTN_HEADS), f32) * 0.5
    dn_a_log = jnp.log(jax.random.uniform(ks[4], (DEPTH, DN_HEADS), f32, 1.0, 16.0))
    dt = jnp.exp(jax.random.uniform(ks[5], (DEPTH, DN_HEADS), f32, float(np.log(1e-3)), float(np.log(1e-1))))
    dn_dt_bias = dt + jnp.log(-jnp.expm1(-dt))
    dn_norm_w = 1.0 + 0.02 * jax.random.normal(ks[6], (DEPTH, DN_VALUE_DIM), f32)
    w_attn_out = jax.random.normal(ks[7], (DEPTH, ATTN_Q_W, D_MODEL), f32) * ATTN_Q_W ** -0.5
    w_dn_out = jax.random.normal(ks[8], (DEPTH, DN_V_W, D_MODEL), f32) * DN_V_W ** -0.5
    w_out = jax.random.normal(ks[9], (DEPTH, D_MODEL, D_MODEL), f32) * (D_MODEL ** -0.5 * DEEPNORM_BETA)
    ln1_g = 1.0 + 0.02 * jax.random.normal(ks[10], (DEPTH, D_MODEL), f32)
    ln1_b = 0.02 * jax.random.normal(ks[11], (DEPTH, D_MODEL), f32)
    w_up = jax.random.normal(ks[12], (DEPTH, D_MODEL, D_FF), f32) * D_MODEL ** -0.5
    w_down = jax.random.normal(ks[13], (DEPTH, D_FF, D_MODEL), f32) * (D_FF ** -0.5 * DEEPNORM_BETA)
    ln2_g = 1.0 + 0.02 * jax.random.normal(ks[14], (DEPTH, D_MODEL), f32)
    ln2_b = 0.02 * jax.random.normal(ks[15], (DEPTH, D_MODEL), f32)
    return {"x": x, "w_in": w_in, "conv_w": conv_w, "attn_sinks": attn_sinks,
            "dn_a_log": dn_a_log, "dn_dt_bias": dn_dt_bias, "dn_norm_w": dn_norm_w,
            "w_attn_out": w_attn_out, "w_dn_out": w_dn_out, "w_out": w_out,
            "ln1_g": ln1_g, "ln1_b": ln1_b, "w_up": w_up, "w_down": w_down,
            "ln2_g": ln2_g, "ln2_b": ln2_b}


def reference(x, w_in, conv_w, attn_sinks, dn_a_log, dn_dt_bias, dn_norm_w, w_attn_out, w_dn_out, w_out,
              ln1_g, ln1_b, w_up, w_down, ln2_g, ln2_b):
    for l in range(DEPTH):
        mix = hybrid_mixer(x, w_in[l], conv_w[l], attn_sinks[l], dn_a_log[l], dn_dt_bias[l], dn_norm_w[l],
                           w_attn_out[l], w_dn_out[l], w_out[l])
        x = layer_norm(DEEPNORM_ALPHA * x + mix, ln1_g[l], ln1_b[l])
        h = jnp.square(jax.nn.relu(x @ w_up[l])) @ w_down[l]
        x = layer_norm(DEEPNORM_ALPHA * x + h, ln2_g[l], ln2_b[l])
    return x
```

```cpp
#include <hip/hip_runtime.h>
#include <cstdio>
#include <cstdint>

constexpr int NB = 4, T_ = 4096, D_ = 1024, FF_ = 4096;
constexpr int INW = 4872;
constexpr int C_AQ = 0, C_AK = 512, C_AV = 640, C_DQKV = 768, C_DZ = 2304, C_DB = 2816, C_DA = 2820, C_GA = 2824, C_GB = 3848;
constexpr float ALPHA = 1.189207115002721f;

template <int EPI>
__global__ void __launch_bounds__(256) k_gemm(const float* __restrict__ A, const float* __restrict__ Bm, float* __restrict__ C, int M, int N, int K, int lda, int ldb, int ldc) {
    __shared__ float As[16][68];
    __shared__ float Bs[16][68];
    const int tid = threadIdx.x, tx = tid & 15, ty = tid >> 4;
    const int m0 = blockIdx.y * 64, n0 = blockIdx.x * 64;
    float acc[4][4];
#pragma unroll
    for (int i = 0; i < 4; ++i)
#pragma unroll
        for (int j = 0; j < 4; ++j) acc[i][j] = 0.f;
    const int ar = tid >> 2, ak = (tid & 3) * 4;
    const int bk = tid >> 4, bn = (tid & 15) * 4;
    for (int k0 = 0; k0 < K; k0 += 16) {
        const float4 av = *(const float4*)(A + (size_t)(m0 + ar) * lda + k0 + ak);
        float4 bv = make_float4(0.f, 0.f, 0.f, 0.f);
        if (n0 + bn < N) bv = *(const float4*)(Bm + (size_t)(k0 + bk) * ldb + n0 + bn);
        __syncthreads();
        As[ak + 0][ar] = av.x; As[ak + 1][ar] = av.y; As[ak + 2][ar] = av.z; As[ak + 3][ar] = av.w;
        *(float4*)&Bs[bk][bn] = bv;
        __syncthreads();
#pragma unroll
        for (int kk = 0; kk < 16; ++kk) {
            const float4 a4 = *(const float4*)&As[kk][ty * 4];
            const float4 b4 = *(const float4*)&Bs[kk][tx * 4];
            const float a[4] = {a4.x, a4.y, a4.z, a4.w}, b[4] = {b4.x, b4.y, b4.z, b4.w};
#pragma unroll
            for (int i = 0; i < 4; ++i)
#pragma unroll
                for (int j = 0; j < 4; ++j) acc[i][j] += a[i] * b[j];
        }
    }
    if (n0 + tx * 4 < N) {
#pragma unroll
        for (int i = 0; i < 4; ++i) {
            float4 o = make_float4(acc[i][0], acc[i][1], acc[i][2], acc[i][3]);
            if (EPI == 1) { o.x = o.x > 0.f ? o.x * o.x : 0.f; o.y = o.y > 0.f ? o.y * o.y : 0.f; o.z = o.z > 0.f ? o.z * o.z : 0.f; o.w = o.w > 0.f ? o.w * o.w : 0.f; }
            *(float4*)(C + (size_t)(m0 + ty * 4 + i) * ldc + n0 + tx * 4) = o;
        }
    }
}

__device__ __forceinline__ float wave_sum(float v) {
#pragma unroll
    for (int o = 1; o < 64; o <<= 1) v += __shfl_xor(v, o);
    return v;
}
__device__ __forceinline__ float wave_max(float v) {
#pragma unroll
    for (int o = 1; o < 64; o <<= 1) v = fmaxf(v, __shfl_xor(v, o));
    return v;
}

__global__ void __launch_bounds__(512) k_attn(const float* __restrict__ proj, const float* __restrict__ sinks, float* __restrict__ out) {
    const int t = blockIdx.x, h = threadIdx.x >> 6, lane = threadIdx.x & 63, kvh = h >> 2;
    const float* q = proj + (size_t)t * INW + C_AQ + h * 64;
    const int j0 = t - 127 > 0 ? t - 127 : 0, nk = t - j0 + 1;
    float s[2];
#pragma unroll
    for (int r = 0; r < 2; ++r) {
        const int jj = lane + 64 * r;
        if (jj < nk) {
            const float* k = proj + (size_t)(j0 + jj) * INW + C_AK + kvh * 64;
            float d = 0.f;
            for (int e = 0; e < 64; e += 4) { const float4 qv = *(const float4*)(q + e), kv = *(const float4*)(k + e); d += qv.x * kv.x + qv.y * kv.y + qv.z * kv.z + qv.w * kv.w; }
            s[r] = d * 0.125f;
        } else s[r] = -1e30f;
    }
    const float sink = sinks[h];
    const float mx = fmaxf(wave_max(fmaxf(s[0], s[1])), sink);
    const float p0 = (lane < nk) ? __expf(s[0] - mx) : 0.f, p1 = (lane + 64 < nk) ? __expf(s[1] - mx) : 0.f;
    const float sum = wave_sum(p0 + p1) + __expf(sink - mx);
    float acc = 0.f;
    for (int jj = 0; jj < nk; ++jj) {
        const float p = __shfl(jj < 64 ? p0 : p1, jj & 63);
        acc += p * proj[(size_t)(j0 + jj) * INW + C_AV + kvh * 64 + lane];
    }
    out[(size_t)t * 512 + h * 64 + lane] = acc / sum;
}

__global__ void __launch_bounds__(256) k_conv(const float* __restrict__ proj, const float* __restrict__ convw, const float* __restrict__ a_log, const float* __restrict__ dt_bias,
                                              float* __restrict__ qkvn, float* __restrict__ gb) {
    __shared__ float part[6][4];
    const int t = blockIdx.x, tid = threadIdx.x, wave = tid >> 6;
    float y[6];
#pragma unroll
    for (int r = 0; r < 6; ++r) {
        const int c = tid + 256 * r;
        float a = 0.f;
#pragma unroll
        for (int i = 0; i < 4; ++i) { const int tt = t - 3 + i; if (tt >= 0) a += convw[i * 1536 + c] * proj[(size_t)tt * INW + C_DQKV + c]; }
        y[r] = a / (1.f + __expf(-a));
        const float ss = wave_sum(y[r] * y[r]);
        if ((tid & 63) == 0) part[r][wave] = ss;
    }
    __syncthreads();
#pragma unroll
    for (int r = 0; r < 6; ++r) {
        const int c = tid + 256 * r;
        float v = y[r];
        if (r < 4) { const float ss = part[r][wave & ~1] + part[r][wave | 1]; v *= rsqrtf(ss + 1e-6f); }
        qkvn[(size_t)t * 1536 + c] = v;
    }
    if (tid < 4) {
        const float da = proj[(size_t)t * INW + C_DA + tid] + dt_bias[tid];
        const float sp = da > 20.f ? da : log1pf(__expf(da));
        gb[(size_t)t * 8 + tid] = -__expf(a_log[tid]) * sp;
        const float db = proj[(size_t)t * INW + C_DB + tid];
        gb[(size_t)t * 8 + 4 + tid] = 1.f / (1.f + __expf(-db));
    }
}

__global__ void __launch_bounds__(64) k_delta(const float* __restrict__ qkvn, const float* __restrict__ gb, float* __restrict__ oraw) {
    __shared__ float ks[32][128];
    __shared__ float qs[32][128];
    const int h = blockIdx.x, e = blockIdx.y * 64 + threadIdx.x, lane = threadIdx.x;
    float S[128];
#pragma unroll
    for (int d = 0; d < 128; ++d) S[d] = 0.f;
    for (int t0 = 0; t0 < T_; t0 += 32) {
        __syncthreads();
        for (int i = lane; i < 32 * 32; i += 64) {
            const int r = i >> 5, c4 = (i & 31) * 4;
            *(float4*)&qs[r][c4] = *(const float4*)(qkvn + (size_t)(t0 + r) * 1536 + h * 128 + c4);
            *(float4*)&ks[r][c4] = *(const float4*)(qkvn + (size_t)(t0 + r) * 1536 + 512 + h * 128 + c4);
        }
        __syncthreads();
        for (int r = 0; r < 32; ++r) {
            const int t = t0 + r;
            const float g = gb[(size_t)t * 8 + h], beta = gb[(size_t)t * 8 + 4 + h];
            const float v = qkvn[(size_t)t * 1536 + 1024 + h * 128 + e];
            const float a = __expf(g);
            float pred = 0.f;
#pragma unroll
            for (int d = 0; d < 128; d += 4) { const float4 k4 = *(const float4*)&ks[r][d]; pred += k4.x * S[d] + k4.y * S[d + 1] + k4.z * S[d + 2] + k4.w * S[d + 3]; }
            const float coef = beta * (v - a * pred);
            float o = 0.f;
#pragma unroll
            for (int d = 0; d < 128; d += 4) {
                const float4 k4 = *(const float4*)&ks[r][d]; const float4 q4 = *(const float4*)&qs[r][d];
                S[d] = a * S[d] + k4.x * coef; S[d + 1] = a * S[d + 1] + k4.y * coef; S[d + 2] = a * S[d + 2] + k4.z * coef; S[d + 3] = a * S[d + 3] + k4.w * coef;
                o += q4.x * S[d] + q4.y * S[d + 1] + q4.z * S[d + 2] + q4.w * S[d + 3];
            }
            oraw[(size_t)t * 512 + h * 128 + e] = o * 0.08838834764831845f;
        }
    }
}

__global__ void __launch_bounds__(512) k_rmsgate(const float* __restrict__ oraw, const float* __restrict__ proj, const float* __restrict__ nw, float* __restrict__ og) {
    __shared__ float part[8];
    const int t = blockIdx.x, tid = threadIdx.x, wave = tid >> 6;
    const float o = oraw[(size_t)t * 512 + tid];
    const float ss = wave_sum(o * o);
    if ((tid & 63) == 0) part[wave] = ss;
    __syncthreads();
    const float ms = (part[wave & ~1] + part[wave | 1]) * (1.f / 128.f);
    const float z = proj[(size_t)t * INW + C_DZ + tid];
    og[(size_t)t * 512 + tid] = o * rsqrtf(ms + 1e-6f) * nw[tid & 127] * (z / (1.f + __expf(-z)));
}

__global__ void __launch_bounds__(256) k_merge(const float* __restrict__ proj, const float* __restrict__ ya, const float* __restrict__ yb, float* __restrict__ merged) {
    const int t = blockIdx.x;
    for (int c = threadIdx.x; c < 1024; c += 256) {
        const float ga = proj[(size_t)t * INW + C_GA + c], gbv = proj[(size_t)t * INW + C_GB + c];
        merged[(size_t)t * 1024 + c] = ya[(size_t)t * 1024 + c] / (1.f + __expf(-ga)) + yb[(size_t)t * 1024 + c] / (1.f + __expf(-gbv));
    }
}

__global__ void __launch_bounds__(256) k_ln(const float* __restrict__ xin, const float* __restrict__ add, const float* __restrict__ g, const float* __restrict__ bta, float* __restrict__ out) {
    __shared__ float part[4];
    __shared__ float part2[4];
    const int t = blockIdx.x, tid = threadIdx.x, wave = tid >> 6;
    float z[4]; float s = 0.f;
#pragma unroll
    for (int r = 0; r < 4; ++r) { const int c = tid + 256 * r; z[r] = ALPHA * xin[(size_t)t * 1024 + c] + add[(size_t)t * 1024 + c]; s += z[r]; }
    s = wave_sum(s);
    if ((tid & 63) == 0) part[wave] = s;
    __syncthreads();
    const float mu = (part[0] + part[1] + part[2] + part[3]) * (1.f / 1024.f);
    float q = 0.f;
#pragma unroll
    for (int r = 0; r < 4; ++r) { const float d = z[r] - mu; q += d * d; }
    q = wave_sum(q);
    if ((tid & 63) == 0) part2[wave] = q;
    __syncthreads();
    const float rstd = rsqrtf((part2[0] + part2[1] + part2[2] + part2[3]) * (1.f / 1024.f) + 1e-5f);
#pragma unroll
    for (int r = 0; r < 4; ++r) { const int c = tid + 256 * r; out[(size_t)t * 1024 + c] = (z[r] - mu) * rstd * g[c] + bta[c]; }
}

template <int EPI>
static void gemm(const float* A, const float* Bm, float* C, int M, int N, int K, int lda, int ldb, int ldc, hipStream_t st) {
    dim3 grid((N + 63) / 64, M / 64);
    hipLaunchKernelGGL(k_gemm<EPI>, grid, dim3(256), 0, st, A, Bm, C, M, N, K, lda, ldb, ldc);
}

extern "C" void kernel_launch(void* const* d_in, const int* in_sizes, int n_in, void* d_out, int out_size, void* d_ws, size_t ws_size, hipStream_t stream) {
    const float* x = (const float*)d_in[0];
    const float* w_in = (const float*)d_in[1];
    const float* conv_w = (const float*)d_in[2];
    const float* sinks = (const float*)d_in[3];
    const float* a_log = (const float*)d_in[4];
    const float* dt_bias = (const float*)d_in[5];
    const float* norm_w = (const float*)d_in[6];
    const float* w_ao = (const float*)d_in[7];
    const float* w_do = (const float*)d_in[8];
    const float* w_out = (const float*)d_in[9];
    const float* ln1_g = (const float*)d_in[10];
    const float* ln1_b = (const float*)d_in[11];
    const float* w_up = (const float*)d_in[12];
    const float* w_down = (const float*)d_in[13];
    const float* ln2_g = (const float*)d_in[14];
    const float* ln2_b = (const float*)d_in[15];
    float* out = (float*)d_out;
    float* ws = (float*)d_ws;
    float* proj = ws;
    float* attn = proj + (size_t)T_ * INW;
    float* qkvn = attn + (size_t)T_ * 512;
    float* gb = qkvn + (size_t)T_ * 1536;
    float* oraw = gb + (size_t)T_ * 8;
    float* og = oraw + (size_t)T_ * 512;
    float* ya = og + (size_t)T_ * 512;
    float* yb = ya + (size_t)T_ * 1024;
    float* x1 = yb + (size_t)T_ * 1024;
    float* hid = proj;
    for (int b = 0; b < NB; ++b) {
        const float* xb = x + (size_t)b * T_ * D_;
        float* ob = out + (size_t)b * T_ * D_;
        gemm<0>(xb, w_in, proj, T_, INW, D_, D_, INW, INW, stream);
        hipLaunchKernelGGL(k_attn, dim3(T_), dim3(512), 0, stream, proj, sinks, attn);
        hipLaunchKernelGGL(k_conv, dim3(T_), dim3(256), 0, stream, proj, conv_w, a_log, dt_bias, qkvn, gb);
        hipLaunchKernelGGL(k_delta, dim3(4, 2), dim3(64), 0, stream, qkvn, gb, oraw);
        hipLaunchKernelGGL(k_rmsgate, dim3(T_), dim3(512), 0, stream, oraw, proj, norm_w, og);
        gemm<0>(attn, w_ao, ya, T_, D_, 512, 512, D_, D_, stream);
        gemm<0>(og, w_do, yb, T_, D_, 512, 512, D_, D_, stream);
        hipLaunchKernelGGL(k_merge, dim3(T_), dim3(256), 0, stream, proj, ya, yb, ya);
        gemm<0>(ya, w_out, yb, T_, D_, D_, D_, D_, D_, stream);
        hipLaunchKernelGGL(k_ln, dim3(T_), dim3(256), 0, stream, xb, yb, ln1_g, ln1_b, x1);
        gemm<1>(x1, w_up, hid, T_, FF_, D_, D_, FF_, FF_, stream);
        gemm<0>(hid, w_down, yb, T_, D_, FF_, FF_, D_, D_, stream);
        hipLaunchKernelGGL(k_ln, dim3(T_), dim3(256), 0, stream, x1, yb, ln2_g, ln2_b, ob);
    }
}
```
